# Optimizing an MI355X kernel written in HIP

```python
import math
import jax, jax.numpy as jnp
from jax import lax
import numpy as np

D_MODEL = 1024
BATCH = 8
SEQ = 2048
DEPTH = 2
DEC_BATCH = 16
DEC_SEQ = 2048
PAST_LEN = 128

HEAD_DIM = 64
A_HEADS = D_MODEL // 128
A_WIDTH = A_HEADS * HEAD_DIM
DILATED_PATTERNS = ((128, 1), (512, 4), (2048, 16))
R_HEADS = D_MODEL // 256
R_KEY_DIM = HEAD_DIM
R_VAL_DIM = 2 * HEAD_DIM
R_QK_WIDTH = R_HEADS * R_KEY_DIM
R_WIDTH = R_HEADS * R_VAL_DIM
MIX_WIDTH = A_WIDTH + R_WIDTH
IN_SPLITS = (A_WIDTH, A_WIDTH, A_WIDTH, A_WIDTH, R_QK_WIDTH, R_QK_WIDTH, R_WIDTH, R_WIDTH)
IN_WIDTH = sum(IN_SPLITS)
CHUNK = 128
ROPE_THETA = 10000.0
EPS = 1e-6
NEG = -1e30

kernel_name = "hybrid_dilated_attn_retention_encoder"


def rmsnorm(x, g):
    xf = x.astype(jnp.float32)
    y = xf * lax.rsqrt(jnp.mean(xf * xf, axis=-1, keepdims=True) + EPS)
    return (y * g.astype(jnp.float32)).astype(x.dtype)


def rope(x):
    S, dh = x.shape[1], x.shape[-1]
    inv = ROPE_THETA ** (-jnp.arange(0, dh, 2, dtype=jnp.float32) / dh)
    ang = jnp.arange(S, dtype=jnp.float32)[:, None] * inv[None, :]
    cos = jnp.cos(ang)[None, :, None, :].astype(x.dtype)
    sin = jnp.sin(ang)[None, :, None, :].astype(x.dtype)
    x1, x2 = x[..., : dh // 2], x[..., dh // 2:]
    return jnp.concatenate([x1 * cos - x2 * sin, x2 * cos + x1 * sin], axis=-1)


def dilated_attention(q, k, v, window, dilation):
    B, S, H, dh = q.shape
    R = window // (2 * dilation)
    blk = R
    L = S // dilation
    nb = -(-L // blk)
    Lp = nb * blk

    def to_classes(t):
        return t.reshape(B, L, dilation, H, dh).transpose(0, 2, 1, 3, 4)

    qc = jnp.pad(to_classes(q), ((0, 0), (0, 0), (0, Lp - L), (0, 0), (0, 0)))
    qc = qc.reshape(B, dilation, nb, blk, H, dh)

    def windows(t):
        tp = jnp.pad(to_classes(t), ((0, 0), (0, 0), (blk, Lp - L + blk), (0, 0), (0, 0)))
        tp = tp.reshape(B, dilation, nb + 2, blk, H, dh)
        return jnp.concatenate([tp[:, :, :-2], tp[:, :, 1:-1], tp[:, :, 2:]], axis=3)

    kw, vw = windows(k), windows(v)
    s = jnp.einsum('bdnqhe,bdnkhe->bdnhqk', qc, kw).astype(jnp.float32)
    l_q = jnp.arange(nb)[:, None, None] * blk + jnp.arange(blk)[None, :, None]
    l_k = (jnp.arange(nb)[:, None, None] - 1) * blk + jnp.arange(3 * blk)[None, None, :]
    valid = (l_k >= 0) & (l_k < L) & (jnp.abs(l_q - l_k) <= R)
    s = jnp.where(valid[None, None, :, None], s, NEG)
    lse = jax.nn.logsumexp(s, axis=-1)
    p = jnp.exp(s - lse[..., None]).astype(v.dtype)
    o = jnp.einsum('bdnhqk,bdnkhe->bdnqhe', p, vw)
    o = o.reshape(B, dilation, Lp, H, dh)[:, :, :L].transpose(0, 2, 1, 3, 4).reshape(B, S, H, dh)
    lse = lse.transpose(0, 1, 2, 4, 3).reshape(B, dilation, Lp, H)[:, :, :L]
    lse = lse.transpose(0, 2, 1, 3).reshape(B, S, H)
    return o, lse


def retention_direction(q, k, v, log_g, strict):
    B, S, H, dk = q.shape
    dv = v.shape[-1]
    nC = S // CHUNK
    q = q.reshape(B, nC, CHUNK, H, dk)
    k = k.reshape(B, nC, CHUNK, H, dk)
    v = v.reshape(B, nC, CHUNK, H, dv)
    t = jnp.arange(CHUNK, dtype=jnp.float32)
    diff = t[:, None] - t[None, :]
    mask = (diff > 0) if strict else (diff >= 0)
    D = jnp.where(mask[None], jnp.exp(jnp.where(mask, diff, 0.0)[None] * log_g[:, None, None]), 0.0)
    inner = jnp.einsum('bnthe,bnshe->bnhts', q, k) * D[None, None]
    y = jnp.einsum('bnhts,bnshf->bnthf', inner, v)
    kdec = k * jnp.exp((CHUNK - 1 - t)[:, None] * log_g[None, :])[None, None, :, :, None]
    chunk_kv = jnp.einsum('bnshe,bnshf->nbhef', kdec, v)
    g_chunk = jnp.exp(CHUNK * log_g)[None, :, None, None]

    def step(state, kv):
        return g_chunk * state + kv, state

    _, state_prev = lax.scan(step, jnp.zeros((B, H, dk, dv), jnp.float32), chunk_kv)
    qdec = q * jnp.exp((t + 1.0)[:, None] * log_g[None, :])[None, None, :, :, None]
    y = y + jnp.einsum('bnthe,nbhef->bnthf', qdec, state_prev)
    return y.reshape(B, S, H, dv)


def encoder_layer(x, c, g_norm, w_ada, b_ada, w_in, w_out, decay_fwd, decay_bwd):
    B, S, _ = x.shape
    mod = jax.nn.silu(c) @ w_ada + b_ada
    shift, scale, gate = jnp.split(mod, 3, axis=-1)
    h = rmsnorm(x, g_norm) * (1.0 + scale[:, None, :]) + shift[:, None, :]
    proj = h @ w_in
    idx = list(np.cumsum(IN_SPLITS)[:-1])
    qa, ka, va, ga, qb, kb, vb, gb = jnp.split(proj, idx, axis=-1)

    qa = rope(qa.reshape(B, S, A_HEADS, HEAD_DIM)) * (HEAD_DIM ** -0.5)
    ka = rope(ka.reshape(B, S, A_HEADS, HEAD_DIM))
    va = va.reshape(B, S, A_HEADS, HEAD_DIM)
    outs, lses = [], []
    for window, dilation in DILATED_PATTERNS:
        o_p, lse_p = dilated_attention(qa, ka, va, window, dilation)
        outs.append(o_p)
        lses.append(lse_p)
    wts = jax.nn.softmax(jnp.stack(lses, axis=0), axis=0).astype(x.dtype)
    oa = jnp.einsum('pbsh,pbshe->bshe', wts, jnp.stack(outs, axis=0))
    ya = oa.reshape(B, S, A_WIDTH) * jax.nn.silu(ga)

    qf = rope(qb.reshape(B, S, R_HEADS, R_KEY_DIM)).astype(jnp.float32)
    kf = rope(kb.reshape(B, S, R_HEADS, R_KEY_DIM)).astype(jnp.float32) * (R_KEY_DIM ** -0.5)
    vf = vb.reshape(B, S, R_HEADS, R_VAL_DIM).astype(jnp.float32)
    lg_f = jax.nn.log_sigmoid(decay_fwd.astype(jnp.float32))
    lg_b = jax.nn.log_sigmoid(decay_bwd.astype(jnp.float32))
    yf = retention_direction(qf, kf, vf, lg_f, False)
    yb = retention_direction(qf[:, ::-1], kf[:, ::-1], vf[:, ::-1], lg_b, True)[:, ::-1]
    r = yf + yb
    r = r * lax.rsqrt(jnp.mean(r * r, axis=-1, keepdims=True) + EPS)
    yr = r.astype(x.dtype).reshape(B, S, R_WIDTH) * jax.nn.silu(gb)

    out = jnp.concatenate([ya, yr], axis=-1) @ w_out
    return x + gate[:, None, :] * out


def trunk(x, c, g_norm, w_ada, b_ada, w_in, w_out, decay_fwd, decay_bwd, g_final):
    for l in range(DEPTH):
        x = encoder_layer(x, c, g_norm[l], w_ada[l], b_ada[l], w_in[l], w_out[l],
                          decay_fwd[l], decay_bwd[l])
    return rmsnorm(x, g_final)


def setup_inputs(seed: int = 0) -> dict:
    key = jax.random.key(seed)
    ks = jax.random.split(key, 14)
    f32 = jnp.float32
    base = 1.0 - 2.0 ** (-5.0 - jnp.arange(R_HEADS, dtype=f32))
    base_logit = jnp.log(base / (1.0 - base))
    return {
        "x_prompt": jax.random.normal(ks[0], (BATCH, SEQ, D_MODEL), f32),
        "x_sample": jax.random.normal(ks[1], (DEC_BATCH, DEC_SEQ, D_MODEL), f32),
        "c_prompt": jax.random.normal(ks[2], (BATCH, D_MODEL), f32),
        "c_sample": jax.random.normal(ks[3], (DEC_BATCH, D_MODEL), f32),
        "g_norm": 1.0 + 0.02 * jax.random.normal(ks[4], (DEPTH, D_MODEL), f32),
        "w_ada": 0.5 * D_MODEL ** -0.5 * jax.random.normal(ks[5], (DEPTH, D_MODEL, 3 * D_MODEL), f32),
        "b_ada": 0.02 * jax.random.normal(ks[6], (DEPTH, 3 * D_MODEL), f32),
        "w_in": D_MODEL ** -0.5 * jax.random.normal(ks[7], (DEPTH, D_MODEL, IN_WIDTH), f32),
        "w_out": MIX_WIDTH ** -0.5 * jax.random.normal(ks[8], (DEPTH, MIX_WIDTH, D_MODEL), f32),
        "decay_fwd": base_logit[None] + 0.1 * jax.random.normal(ks[9], (DEPTH, R_HEADS), f32),
        "decay_bwd": base_logit[None] + 0.1 * jax.random.normal(ks[10], (DEPTH, R_HEADS), f32),
        "g_final": 1.0 + 0.02 * jax.random.normal(ks[11], (D_MODEL,), f32),
    }


def reference(x_prompt, x_sample, c_prompt, c_sample, g_norm, w_ada, b_ada, w_in, w_out,
              decay_fwd, decay_bwd, g_final):
    y_prompt = trunk(x_prompt, c_prompt, g_norm, w_ada, b_ada, w_in, w_out,
                     decay_fwd, decay_bwd, g_final)
    y_sample = trunk(x_sample, c_sample, g_norm, w_ada, b_ada, w_in, w_out,
                     decay_fwd, decay_bwd, g_final)
    return (y_prompt, y_sample)
```

```cpp
#include <hip/hip_runtime.h>
#include <cstdio>
#include <cstdint>
namespace nv {
constexpr int D = 1024, S = 2048, NSEQ = 24, NPROMPT = 8, DEPTH = 2, INW = 3584, MODW = 3072;
constexpr int GSEQ = 4, MG = GSEQ * S;
__device__ __forceinline__ float silu_f(float v) { return v / (1.f + expf(-v)); }

struct In { const float *xp, *xs, *cp, *cs, *gn, *wada, *bada, *win, *wout, *df, *db, *gf; };

__device__ __forceinline__ const float* xrow(const In& I, int grow) {
    return grow < NPROMPT * S ? I.xp + (size_t)grow * D : I.xs + (size_t)(grow - NPROMPT * S) * D;
}

__global__ void k_mod(In I, float* mod) {
    const int idx = blockIdx.x * 256 + threadIdx.x; if (idx >= DEPTH * NSEQ * MODW) return;
    const int j = idx % MODW, b = (idx / MODW) % NSEQ, l = idx / (MODW * NSEQ);
    const float* c = b < NPROMPT ? I.cp + b * D : I.cs + (b - NPROMPT) * D;
    const float* w = I.wada + (size_t)l * D * MODW + j;
    float acc = 0.f;
    for (int k = 0; k < D; ++k) acc += silu_f(c[k]) * w[(size_t)k * MODW];
    mod[idx] = acc + I.bada[l * MODW + j];
}
__global__ void k_norm(const float* X, int layer0, In I, int l, int g0, const float* mod, float* H) {
    const int lane = threadIdx.x & 63, row = blockIdx.x * 4 + (threadIdx.x >> 6);
    const int grow = g0 + row, b = grow >> 11;
    const float* x = layer0 ? xrow(I, grow) : X + (size_t)row * D;
    float v[16]; float ss = 0.f;
#pragma unroll
    for (int i = 0; i < 16; ++i) { v[i] = x[lane + 64 * i]; ss += v[i] * v[i]; }
    for (int o = 1; o < 64; o <<= 1) ss += __shfl_xor(ss, o);
    const float rstd = rsqrtf(ss * (1.f / D) + 1e-6f);
    const float* md = mod + ((size_t)l * NSEQ + b) * MODW;
#pragma unroll
    for (int i = 0; i < 16; ++i) { const int k = lane + 64 * i; H[(size_t)row * D + k] = v[i] * rstd * I.gn[l * D + k] * (1.f + md[D + k]) + md[k]; }
}
__global__ void k_gemm(const float* A, const float* B, float* C, int M, int N, int K) {
    __shared__ float As[16][68], Bs[16][68];
    const int tx = threadIdx.x & 15, ty = threadIdx.x >> 4, m0 = blockIdx.y * 64, n0 = blockIdx.x * 64;
    float acc[4][4] = {};
    for (int k0 = 0; k0 < K; k0 += 16) {
        for (int i = threadIdx.x; i < 1024; i += 256) { const int r = i >> 4, c = i & 15; As[c][r] = A[(size_t)(m0 + r) * K + k0 + c]; }
        for (int i = threadIdx.x; i < 1024; i += 256) { const int r = i >> 6, c = i & 63; Bs[r][c] = B[(size_t)(k0 + r) * N + n0 + c]; }
        __syncthreads();
#pragma unroll
        for (int k = 0; k < 16; ++k) { float a[4], b[4];
#pragma unroll
            for (int i = 0; i < 4; ++i) { a[i] = As[k][ty * 4 + i]; b[i] = Bs[k][tx * 4 + i]; }
#pragma unroll
            for (int i = 0; i < 4; ++i)
#pragma unroll
                for (int j = 0; j < 4; ++j) acc[i][j] += a[i] * b[j]; }
        __syncthreads();
    }
    for (int i = 0; i < 4; ++i) for (int j = 0; j < 4; ++j) C[(size_t)(m0 + ty * 4 + i) * N + n0 + tx * 4 + j] = acc[i][j];
}
__global__ void k_rope(float* P, int g0) {
    const int idx = blockIdx.x * 256 + threadIdx.x; const int i = idx & 31, slot = (idx >> 5) % 24, row = idx / (32 * 24);
    if (row >= MG) return;
    const int pos = (g0 + row) & (S - 1);
    int col; float sc = 1.f;
    if (slot < 8) { col = slot * 64; sc = 0.125f; } else if (slot < 16) col = 512 + (slot - 8) * 64; else if (slot < 20) col = 2048 + (slot - 16) * 64; else { col = 2304 + (slot - 20) * 64; sc = 0.125f; }
    const float inv = powf(10000.f, -(float)(2 * i) / 64.f); const float ang = (float)pos * inv;
    const float c = cosf(ang), s = sinf(ang);
    float* p = P + (size_t)row * INW + col; const float x1 = p[i], x2 = p[32 + i];
    p[i] = (x1 * c - x2 * s) * sc; p[32 + i] = (x2 * c + x1 * s) * sc;
}
__global__ void __launch_bounds__(128) k_attn(const float* P, float* OP, float* LSE) {
    const int idx = blockIdx.x * 128 + threadIdx.x; const int row = idx % MG, h = (idx / MG) & 7, p = idx / (MG * 8);
    if (p >= 3) return;
    const int pos = row & (S - 1), sb = row - pos, d = p == 0 ? 1 : (p == 1 ? 4 : 16), r = pos % d, l = pos / d, L = S / d;
    float q[64], o[64];
#pragma unroll
    for (int i = 0; i < 64; ++i) { q[i] = P[(size_t)row * INW + h * 64 + i]; o[i] = 0.f; }
    float m = -INFINITY, ls = 0.f;
    const int lo = l - 64 < 0 ? 0 : l - 64, hi = l + 64 > L - 1 ? L - 1 : l + 64;
    for (int lk = lo; lk <= hi; ++lk) {
        const float* kr = P + (size_t)(sb + lk * d + r) * INW + 512 + h * 64; const float* vr = kr + 512;
        float s = 0.f;
#pragma unroll
        for (int i = 0; i < 64; ++i) s += q[i] * kr[i];
        const float mn = fmaxf(m, s), f = expf(m - mn), pe = expf(s - mn);
        ls = ls * f + pe;
#pragma unroll
        for (int i = 0; i < 64; ++i) o[i] = o[i] * f + pe * vr[i];
        m = mn;
    }
    const float il = 1.f / ls;
#pragma unroll
    for (int i = 0; i < 64; ++i) OP[((size_t)p * MG + row) * 512 + h * 64 + i] = o[i] * il;
    LSE[((size_t)p * MG + row) * 8 + h] = m + logf(ls);
}
__global__ void k_attn_merge(const float* P, const float* OP, const float* LSE, float* MIX) {
    const int idx = blockIdx.x * 256 + threadIdx.x; const int c = idx & 511, row = idx >> 9; if (row >= MG) return;
    const int h = c >> 6;
    const float l0 = LSE[((size_t)0 * MG + row) * 8 + h], l1 = LSE[((size_t)1 * MG + row) * 8 + h], l2 = LSE[((size_t)2 * MG + row) * 8 + h];
    const float mx = fmaxf(l0, fmaxf(l1, l2)); const float w0 = expf(l0 - mx), w1 = expf(l1 - mx), w2 = expf(l2 - mx), iw = 1.f / (w0 + w1 + w2);
    const float oa = (w0 * OP[((size_t)0 * MG + row) * 512 + c] + w1 * OP[((size_t)1 * MG + row) * 512 + c] + w2 * OP[((size_t)2 * MG + row) * 512 + c]) * iw;
    MIX[(size_t)row * D + c] = oa * silu_f(P[(size_t)row * INW + 1536 + c]);
}
__global__ void k_ret_norm(const float* P, float* MIX) {
    const int lane = threadIdx.x & 63, w = blockIdx.x * 4 + (threadIdx.x >> 6), row = w >> 2, h = w & 3;
    float* y = MIX + (size_t)row * D + 512 + h * 128; const float a = y[lane], b = y[lane + 64];
    float ss = a * a + b * b;
    for (int o = 1; o < 64; o <<= 1) ss += __shfl_xor(ss, o);
    const float rstd = rsqrtf(ss * (1.f / 128.f) + 1e-6f);
    const float* g = P + (size_t)row * INW + 3072 + h * 128;
    y[lane] = a * rstd * silu_f(g[lane]); y[lane + 64] = b * rstd * silu_f(g[lane + 64]);
}
__global__ void k_resid(const float* X, int layer0, In I, int l, int g0, const float* mod, const float* O, float* Xo) {
    const int idx = blockIdx.x * 256 + threadIdx.x; const int j = idx & 1023, row = idx >> 10; if (row >= MG) return;
    const int grow = g0 + row, b = grow >> 11;
    const float x = layer0 ? xrow(I, grow)[j] : X[(size_t)row * D + j];
    Xo[(size_t)row * D + j] = x + mod[((size_t)l * NSEQ + b) * MODW + 2048 + j] * O[(size_t)row * D + j];
}
__global__ void k_final(const float* X, const float* gf, float* out) {
    const int lane = threadIdx.x & 63, row = blockIdx.x * 4 + (threadIdx.x >> 6);
    const float* x = X + (size_t)row * D; float v[16]; float ss = 0.f;
#pragma unroll
    for (int i = 0; i < 16; ++i) { v[i] = x[lane + 64 * i]; ss += v[i] * v[i]; }
    for (int o = 1; o < 64; o <<= 1) ss += __shfl_xor(ss, o);
    const float rstd = rsqrtf(ss * (1.f / D) + 1e-6f);
#pragma unroll
    for (int i = 0; i < 16; ++i) out[(size_t)row * D + lane + 64 * i] = v[i] * rstd * gf[lane + 64 * i];
}
__global__ void k_lg(In I, float* lg) {
    const int t = threadIdx.x; if (t >= 16) return; const int h = t & 3, dir = (t >> 2) & 1, l = t >> 3;
    const float x = (dir ? I.db : I.df)[l * 4 + h]; lg[t] = fminf(x, 0.f) - log1pf(expf(-fabsf(x)));
}
__global__ void __launch_bounds__(128) k_ret2(const float* P, const float* lg, int l, float* MIX) {
    const int idx = blockIdx.x * 128 + threadIdx.x; const int row = idx % MG, fq = (idx / MG) & 3, h = idx / (MG * 4);
    if (h >= 4) return;
    const float lgf = lg[l * 8 + h], lgb = lg[l * 8 + 4 + h];
    const int n = row & (S - 1), sb = row - n;
    float q[64], y[32];
#pragma unroll
    for (int i = 0; i < 64; ++i) q[i] = P[(size_t)row * INW + 2048 + h * 64 + i];
#pragma unroll
    for (int i = 0; i < 32; ++i) y[i] = 0.f;
    for (int m = 0; m < S; ++m) {
        const float* kr = P + (size_t)(sb + m) * INW + 2304 + h * 64; const float* vr = P + (size_t)(sb + m) * INW + 2560 + h * 128 + fq * 32;
        float s = 0.f;
#pragma unroll
        for (int i = 0; i < 64; ++i) s += q[i] * kr[i];
        const float w = s * (m <= n ? expf((float)(n - m) * lgf) : expf((float)(m - n) * lgb));
#pragma unroll
        for (int i = 0; i < 32; ++i) y[i] += w * vr[i];
    }
#pragma unroll
    for (int i = 0; i < 32; ++i) MIX[(size_t)row * D + 512 + h * 128 + fq * 32 + i] = y[i];
}

struct Ws { float *mod, *lg, *X, *H, *P, *OP, *LSE, *MIX, *O; };
inline size_t ws_floats() { return (size_t)DEPTH * NSEQ * MODW + 64 + (size_t)MG * D * 4 + (size_t)MG * INW + (size_t)3 * MG * 512 + (size_t)3 * MG * 8; }
inline Ws carve(float* base) {
    Ws w; float* p = base;
    w.mod = p; p += (size_t)DEPTH * NSEQ * MODW; w.lg = p; p += 64;
    w.X = p; p += (size_t)MG * D; w.H = p; p += (size_t)MG * D; w.MIX = p; p += (size_t)MG * D; w.O = p; p += (size_t)MG * D;
    w.P = p; p += (size_t)MG * INW; w.OP = p; p += (size_t)3 * MG * 512; w.LSE = p; p += (size_t)3 * MG * 8;
    return w;
}
inline void run_group(const In& I, const Ws& w, int g0, float* out, hipStream_t st, float* keepMIX = nullptr, float* keepX1 = nullptr, float* keepP = nullptr) {
    for (int l = 0; l < DEPTH; ++l) {
        k_norm<<<MG / 4, 256, 0, st>>>(w.X, l == 0, I, l, g0, w.mod, w.H);
        k_gemm<<<dim3(INW / 64, MG / 64), 256, 0, st>>>(w.H, I.win + (size_t)l * D * INW, w.P, MG, INW, D);
        k_rope<<<(MG * 24 * 32 + 255) / 256, 256, 0, st>>>(w.P, g0);
        if (l == 0 && keepP) (void)hipMemcpyAsync(keepP, w.P, (size_t)MG * INW * 4, hipMemcpyDeviceToDevice, st);
        k_attn<<<(MG * 8 * 3 + 127) / 128, 128, 0, st>>>(w.P, w.OP, w.LSE);
        k_attn_merge<<<MG * 512 / 256, 256, 0, st>>>(w.P, w.OP, w.LSE, w.MIX);
        k_ret2<<<(MG * 16 + 127) / 128, 128, 0, st>>>(w.P, w.lg, l, w.MIX);
        k_ret_norm<<<MG, 256, 0, st>>>(w.P, w.MIX);
        if (l == 0 && keepMIX) (void)hipMemcpyAsync(keepMIX, w.MIX, (size_t)MG * D * 4, hipMemcpyDeviceToDevice, st);
        k_gemm<<<dim3(D / 64, MG / 64), 256, 0, st>>>(w.MIX, I.wout + (size_t)l * D * D, w.O, MG, D, D);
        k_resid<<<MG * D / 256, 256, 0, st>>>(w.X, l == 0, I, l, g0, w.mod, w.O, w.X);
        if (l == 0 && keepX1) (void)hipMemcpyAsync(keepX1, w.X, (size_t)MG * D * 4, hipMemcpyDeviceToDevice, st);
    }
    k_final<<<MG / 4, 256, 0, st>>>(w.X, I.gf, out + (size_t)g0 * D);
}
inline void run_all(const In& I, float* wsbase, float* out, hipStream_t st) {
    const Ws w = carve(wsbase);
    k_mod<<<(DEPTH * NSEQ * MODW + 255) / 256, 256, 0, st>>>(I, w.mod);
    k_lg<<<1, 64, 0, st>>>(I, w.lg);
    for (int g = 0; g < NSEQ / GSEQ; ++g) run_group(I, w, g * MG, out, st);
}
}
extern "C" void kernel_launch(void* const* d_in, const int* in_sizes, int n_in, void* d_out, int out_size, void* d_ws, size_t ws_size, hipStream_t stream) {
    if (n_in != 12 || out_size != nv::NSEQ * nv::S * nv::D || ws_size < nv::ws_floats() * 4) { fprintf(stderr, "kernel_launch: unexpected shapes (n_in %d out %d ws %zu)\n", n_in, out_size, ws_size); return; }
    nv::In I{(const float*)d_in[0], (const float*)d_in[1], (const float*)d_in[2], (const float*)d_in[3], (const float*)d_in[4], (const float*)d_in[5], (const float*)d_in[6],
             (const float*)d_in[7], (const float*)d_in[8], (const float*)d_in[9], (const float*)d_in[10], (const float*)d_in[11]};
    nv::run_all(I, (float*)d_ws, (float*)d_out, stream);
}
```

```cpp
#include <hip/hip_runtime.h>
#include <cstdio>
#include <cstdint>
#include <cmath>
namespace pg8 {
#define PG8_LAS __attribute__((address_space(3)))
typedef unsigned short bf16_t;
typedef short bf16x8 __attribute__((ext_vector_type(8)));
typedef float f32x4 __attribute__((ext_vector_type(4)));
typedef unsigned u32x4 __attribute__((ext_vector_type(4)));
constexpr int BM = 256, BK = 64, HALF = 128, HTB = HALF * BK * 2  , STAGE_BYTES = 8 * HTB, NXCD = 8, WGM = 8;

__host__ __device__ __forceinline__ int lds_byte(int r, int c) { const int st = (r >> 4) * 2 + (c >> 5), rr = r & 15, cc = c & 31, ob = rr * 64 + cc * 2; return st * 1024 + (ob ^ (((ob >> 9) & 1) << 5)); }
__host__ __device__ __forceinline__ void stage_rc(int b, int& R, int& C) { const int st = b / 1024, sb = b % 1024, swz = sb ^ (((sb >> 9) & 1) << 5); R = (st >> 1) * 16 + swz / 64; C = (st & 1) * 32 + (swz % 64) / 2; }
__host__ __device__ __forceinline__ int perm32(int rho) { const int n = rho >> 4, i = rho & 15; return 8 * (i >> 2) + 4 * n + (i & 3); }

struct Unit { int pm, pn; };
struct Gemm { const bf16_t* A; const bf16_t* Bt; int M, N, K; };

struct StaticOrder {
    int nM, nN, nwg, G, c;
    __host__ __device__ void init(int M, int N, int G_, int c_) { nM = M / BM; nN = N / BM; nwg = nM * nN; G = G_; c = c_; }
    __host__ __device__ bool next(int i, Unit& u) const {
        const long L = (long)i * G + c; if (L >= nwg) return false;
        int wgid = (int)L; { const int q = nwg / NXCD, r = nwg % NXCD, xcd = wgid % NXCD, off = wgid / NXCD; wgid = (xcd < r ? xcd * (q + 1) : r * (q + 1) + (xcd - r) * q) + off; }
        const int nig = WGM * nN, gid = wgid / nig, fm = gid * WGM, gsz = (nM - fm) < WGM ? (nM - fm) : WGM;
        u.pm = fm + ((wgid % nig) % gsz); u.pn = (wgid % nig) / gsz; return true;
    }
    __device__ __forceinline__ void a_ready(const Unit&) const {}
    __device__ __forceinline__ void done(const Unit&) const {}
};

__device__ __forceinline__ unsigned cvt_pk_bf16(float lo, float hi) { unsigned r; asm volatile("v_cvt_pk_bf16_f32 %0, %1, %2" : "=v"(r) : "v"(lo), "v"(hi)); return r; }
typedef float f32x2 __attribute__((ext_vector_type(2)));
template <class Epi, class Sched, bool ALIGN_EPI = false, bool SP2 = false>
__device__ __forceinline__ void gemm_phase(PG8_LAS unsigned char* lds, const Gemm g, const Sched& S, const Epi& E) {
    int tid = threadIdx.x; asm volatile("" : "+v"(tid));
    const int wid = __builtin_amdgcn_readfirstlane(tid >> 6), lane = tid & 63, wr = wid >> 2, wc = wid & 3, fr = lane & 15, fq = lane >> 4;
    const int K = g.K, nt = K / BK;
    unsigned voffA[2], voffB[2];
#pragma unroll
    for (int i = 0; i < 2; ++i) { int R, C; stage_rc(tid * 16 + i * 8192, R, C); const int Rb = Epi::PERM ? ((R & ~31) + perm32(R & 31)) : R;
        voffA[i] = (unsigned)(R * K + C) * 2u; voffB[i] = (unsigned)(Rb * K + C) * 2u; }
    const size_t kstep = (size_t)(BK * 2);
    const size_t hstep = (size_t)HALF * K * 2;
    const size_t tstep = 2 * hstep;
    const unsigned ldsw = (unsigned)wid * 1024u;
    const int aoff = lds_byte(wr * 64 + fr, fq * 8), boff = lds_byte(wc * 32 + fr, fq * 8);
#define PG8_SA(b, h) (((b) * 2 + (h)) * HTB)
#define PG8_SB(b, h) ((4 + (b) * 2 + (h)) * HTB)
#define PG8_STAGE(bufoff, gbase, voff) do { _Pragma("unroll") for (int _i = 0; _i < 2; ++_i) \
        __builtin_amdgcn_global_load_lds((const unsigned*)((const char*)(gbase) + (voff)[_i]), (PG8_LAS unsigned*)(lds + (bufoff) + ldsw + _i * 8192), 16, 0, 0); } while (0)
#define PG8_LDA(dst, b, h) do { _Pragma("unroll") for (int m = 0; m < 4; ++m) _Pragma("unroll") for (int k = 0; k < 2; ++k) dst[m][k] = *(const PG8_LAS bf16x8*)(lds + PG8_SA(b, h) + aoff + m * 2048 + k * 1024); } while (0)
#define PG8_LDB(dst, b, h) do { _Pragma("unroll") for (int n = 0; n < 2; ++n) _Pragma("unroll") for (int k = 0; k < 2; ++k) dst[n][k] = *(const PG8_LAS bf16x8*)(lds + PG8_SB(b, h) + boff + n * 2048 + k * 1024); } while (0)
#define PG8_MMA(ai, bj, At, Bt) do { __builtin_amdgcn_s_setprio(1); _Pragma("unroll") for (int m = 0; m < 4; ++m) _Pragma("unroll") for (int n = 0; n < 2; ++n) _Pragma("unroll") for (int k = 0; k < 2; ++k) \
        acc[ai][bj][m][n] = __builtin_amdgcn_mfma_f32_16x16x32_bf16(Bt[n][k], At[m][k], acc[ai][bj][m][n], 0, 0, 0); __builtin_amdgcn_s_setprio(0); } while (0)
#define PG8_WAIT_V(n) asm volatile("s_waitcnt vmcnt(" #n ")" ::: "memory")
#define PG8_WAIT_L(n) asm volatile("s_waitcnt lgkmcnt(" #n ")" ::: "memory")
#define PG8_BAR __builtin_amdgcn_s_barrier()
#define PG8_SCHED __builtin_amdgcn_sched_barrier(0)
    Unit cur, nxt; int ui = 0;
    if (!S.next(0, cur)) return;
    f32x4 acc[2][2][4][2];
#pragma unroll
    for (int a = 0; a < 2; ++a)
#pragma unroll
        for (int b = 0; b < 2; ++b)
#pragma unroll
            for (int m = 0; m < 4; ++m)
#pragma unroll
                for (int n = 0; n < 2; ++n) acc[a][b][m][n] = (f32x4){0.f, 0.f, 0.f, 0.f};
    bf16x8 At[4][2], B0[2][2], B1[2][2];
    const char* cA = (const char*)g.A + (size_t)cur.pm * tstep; const char* cB = (const char*)g.Bt + (size_t)cur.pn * tstep;
    S.a_ready(cur);
    if constexpr (SP2) {
        PG8_STAGE(PG8_SB(0, 0), cB, voffB); PG8_STAGE(PG8_SB(0, 1), cB + hstep, voffB); PG8_STAGE(PG8_SA(0, 0), cA, voffA); PG8_STAGE(PG8_SA(0, 1), cA + hstep, voffA);
        if (wr == 1) PG8_BAR;
        PG8_WAIT_V(2); PG8_BAR;
        PG8_STAGE(PG8_SB(1, 0), cB + kstep, voffB); PG8_STAGE(PG8_SA(1, 0), cA + kstep, voffA); PG8_STAGE(PG8_SB(1, 1), cB + hstep + kstep, voffB);
        PG8_WAIT_V(6); PG8_BAR;
    } else {
        PG8_STAGE(PG8_SB(0, 0), cB, voffB); PG8_STAGE(PG8_SA(0, 0), cA, voffA); PG8_STAGE(PG8_SB(0, 1), cB + hstep, voffB); PG8_STAGE(PG8_SA(0, 1), cA + hstep, voffA);
        if (wr == 1) PG8_BAR;
        PG8_WAIT_V(4); PG8_BAR;
        PG8_STAGE(PG8_SB(1, 0), cB + kstep, voffB); PG8_STAGE(PG8_SA(1, 0), cA + kstep, voffA); PG8_STAGE(PG8_SB(1, 1), cB + hstep + kstep, voffB);
        PG8_WAIT_V(6); PG8_BAR;
    }
    for (;;) {
        const bool has_next = S.next(ui + 1, nxt);
        const char* nA = has_next ? (const char*)g.A + (size_t)nxt.pm * tstep : cA; const char* nB = has_next ? (const char*)g.Bt + (size_t)nxt.pn * tstep : cB;
        for (int t = 0; t < nt; t += 2) {
            const bool last = (t == nt - 2);
            const char* a1 = cA + (size_t)(t + 1) * kstep;
            const char* a2 = last ? nA : cA + (size_t)(t + 2) * kstep; const char* b2 = last ? nB : cB + (size_t)(t + 2) * kstep;
            const char* a3 = a2 + kstep; const char* b3 = b2 + kstep;
            if (last && has_next) S.a_ready(nxt);
            if constexpr (SP2) {
            PG8_LDB(B0, 0, 0); PG8_LDB(B1, 0, 1); PG8_SCHED; PG8_LDA(At, 0, 0); PG8_STAGE(PG8_SA(1, 1), a1 + hstep, voffA);
            PG8_WAIT_V(8); PG8_WAIT_L(0); PG8_BAR; PG8_MMA(0, 0, At, B0); PG8_MMA(0, 1, At, B1); PG8_BAR; PG8_SCHED;
            PG8_LDA(At, 0, 1); PG8_STAGE(PG8_SB(0, 0), b2, voffB); PG8_STAGE(PG8_SB(0, 1), b2 + hstep, voffB); PG8_STAGE(PG8_SA(0, 0), a2, voffA);
            PG8_WAIT_V(8); PG8_WAIT_L(0); PG8_BAR; PG8_MMA(1, 0, At, B0); PG8_MMA(1, 1, At, B1); PG8_BAR; PG8_SCHED;
            PG8_LDB(B0, 1, 0); PG8_LDB(B1, 1, 1); PG8_SCHED; PG8_LDA(At, 1, 0); PG8_STAGE(PG8_SA(0, 1), a2 + hstep, voffA);
            PG8_WAIT_V(8); PG8_WAIT_L(0); PG8_BAR; PG8_MMA(0, 0, At, B0); PG8_MMA(0, 1, At, B1); PG8_BAR; PG8_SCHED;
            PG8_LDA(At, 1, 1); PG8_STAGE(PG8_SB(1, 0), b3, voffB); PG8_STAGE(PG8_SB(1, 1), b3 + hstep, voffB); PG8_STAGE(PG8_SA(1, 0), a3, voffA);
            PG8_WAIT_V(8); PG8_WAIT_L(0); PG8_BAR; PG8_MMA(1, 0, At, B0); PG8_MMA(1, 1, At, B1); PG8_BAR; PG8_SCHED;
            } else {
            PG8_LDB(B0, 0, 0); PG8_SCHED; PG8_LDA(At, 0, 0); PG8_STAGE(PG8_SA(1, 1), a1 + hstep, voffA);
            PG8_WAIT_L(8); PG8_BAR; PG8_WAIT_L(0); PG8_MMA(0, 0, At, B0); PG8_BAR; PG8_SCHED;
            PG8_LDB(B1, 0, 1); PG8_STAGE(PG8_SB(0, 0), b2, voffB);
            PG8_BAR; PG8_WAIT_L(0); PG8_MMA(0, 1, At, B1); PG8_BAR;
            PG8_LDA(At, 0, 1); PG8_STAGE(PG8_SA(0, 0), a2, voffA);
            PG8_BAR; PG8_WAIT_L(0); PG8_MMA(1, 0, At, B0); PG8_BAR; PG8_SCHED;
            PG8_STAGE(PG8_SB(0, 1), b2 + hstep, voffB);
            PG8_WAIT_V(6); PG8_BAR; PG8_MMA(1, 1, At, B1); PG8_BAR;
            PG8_LDB(B0, 1, 0); PG8_SCHED; PG8_LDA(At, 1, 0); PG8_STAGE(PG8_SA(0, 1), a2 + hstep, voffA);
            PG8_WAIT_L(8); PG8_BAR; PG8_WAIT_L(0); PG8_MMA(0, 0, At, B0); PG8_BAR; PG8_SCHED;
            PG8_LDB(B1, 1, 1); PG8_STAGE(PG8_SB(1, 0), b3, voffB);
            PG8_BAR; PG8_WAIT_L(0); PG8_MMA(0, 1, At, B1); PG8_BAR;
            PG8_LDA(At, 1, 1); PG8_STAGE(PG8_SA(1, 0), a3, voffA);
            PG8_BAR; PG8_WAIT_L(0); PG8_MMA(1, 0, At, B0); PG8_BAR; PG8_SCHED;
            PG8_STAGE(PG8_SB(1, 1), b3 + hstep, voffB);
            PG8_WAIT_V(6); PG8_BAR; PG8_MMA(1, 1, At, B1); PG8_BAR;
            }
        }
        if constexpr (ALIGN_EPI) { if (wr == 0) PG8_BAR; }
        if constexpr (!Epi::AFTER_DRAIN) { E(acc, cur, wr, wc, fr, fq); S.done(cur); }
        if (!has_next) break;
#pragma unroll
        for (int a = 0; a < 2; ++a)
#pragma unroll
            for (int b = 0; b < 2; ++b)
#pragma unroll
                for (int m = 0; m < 4; ++m)
#pragma unroll
                    for (int n = 0; n < 2; ++n) acc[a][b][m][n] = (f32x4){0.f, 0.f, 0.f, 0.f};
        cur = nxt; cA = nA; cB = nB; ++ui;
        if constexpr (ALIGN_EPI) { if (wr == 1) PG8_BAR; }
    }
    PG8_WAIT_V(0);
    if constexpr (!ALIGN_EPI) { if (wr == 0) PG8_BAR; }
    PG8_BAR;
    if constexpr (Epi::AFTER_DRAIN) { E.fused(acc, cur, wr, wc, fr, fq, lds, wid, lane); S.done(cur); }
#undef PG8_SA
#undef PG8_SB
#undef PG8_STAGE
#undef PG8_LDA
#undef PG8_LDB
#undef PG8_MMA
#undef PG8_WAIT_V
#undef PG8_WAIT_L
#undef PG8_BAR
#undef PG8_SCHED
}
}
#define GAS __attribute__((address_space(1)))
#define LAS __attribute__((address_space(3)))
typedef unsigned short bf16;
typedef unsigned v4u __attribute__((ext_vector_type(4)));
typedef float f32x4 __attribute__((ext_vector_type(4)));
typedef short bf16x8 __attribute__((ext_vector_type(8)));
typedef GAS unsigned gu32;
typedef GAS unsigned long long gu64;
#define RLX_AGENT __ATOMIC_RELAXED, __HIP_MEMORY_SCOPE_AGENT
#define LDS_WAIT() asm volatile("s_waitcnt lgkmcnt(0)" ::: "memory")
#define VM_WAIT() asm volatile("s_waitcnt vmcnt(0)" ::: "memory")
__device__ __forceinline__ unsigned long long rt() { return __builtin_amdgcn_s_memrealtime(); }
__device__ __forceinline__ unsigned f2bf(float f) { unsigned u = __builtin_bit_cast(unsigned, f); return (u + 0x7fffu + ((u >> 16) & 1u)) >> 16; }
__device__ __forceinline__ unsigned pk2(float lo, float hi) { return f2bf(lo) | (f2bf(hi) << 16); }
#define XB_TMO      128
#define XB_XCNT(j)  (256  + 64 * (j))
#define XB_XSUB(j)  (1280 + 64 * (j))
#define XB_XGEN(j)  (2304 + 64 * (j))
#define XB_TOP      3328
#define XB_TOPGEN   3392
#define XCD_BAR_WORDS 3456
#define XB_SPIN_CAP (1u << 18)

__device__ __forceinline__ unsigned xb_ld(unsigned* p)              { return __hip_atomic_load(p, __ATOMIC_RELAXED, __HIP_MEMORY_SCOPE_AGENT); }
__device__ __forceinline__ unsigned xb_add(unsigned* p, unsigned v) { return __hip_atomic_fetch_add(p, v, __ATOMIC_RELAXED, __HIP_MEMORY_SCOPE_AGENT); }
__device__ __forceinline__ unsigned xb_xcc_id() { return (unsigned)__builtin_amdgcn_s_getreg((3 << 11) | 20) & 0xFu; }
#define XB_SPIN(cond, bar) do { unsigned _sp = 0; while (cond) { __builtin_amdgcn_s_sleep(1); \
    if ((++_sp & 255u) == 0u) { if (xb_ld(&(bar)[XB_TMO])) break; if (_sp > XB_SPIN_CAP) { atomicAdd(&(bar)[XB_TMO], 1u); break; } } } } while (0)

struct XcdBarrier {
    unsigned* bar; unsigned x;
    volatile LAS unsigned* st;
};

__device__ __forceinline__ XcdBarrier xcd_barrier_post(unsigned* bar, volatile LAS unsigned* st) {
    XcdBarrier b; b.bar = bar; b.x = xb_xcc_id(); b.st = st;
    if (threadIdx.x == 0) (void)xb_add(&bar[XB_XCNT(b.x)], 1u);
    return b;
}
__device__ __forceinline__ void xcd_barrier_complete(unsigned* bar, unsigned x, unsigned& nloc, unsigned& nx) {
    const unsigned G = gridDim.x * gridDim.y * gridDim.z;
    unsigned sum, cnt, mine, sp = 0u;
    for (;;) {
        sum = 0u; cnt = 0u; mine = 0u;
#pragma unroll
        for (unsigned j = 0; j < 16; ++j) { const unsigned c = xb_ld(&bar[XB_XCNT(j)]); sum += c; cnt += (c > 0u) ? 1u : 0u; mine = (j == x) ? c : mine; }
        if (sum == G) break;
        __builtin_amdgcn_s_sleep(1);
        if ((++sp & 255u) == 0u) { if (xb_ld(&bar[XB_TMO])) break; if (sp > XB_SPIN_CAP) { atomicAdd(&bar[XB_TMO], 1u); break; } }
    }
    nloc = mine > 0u ? mine : 1u; nx = cnt > 0u ? cnt : 1u;
}

__device__ __forceinline__ void xcd_barrier(const XcdBarrier& b) {
    asm volatile("s_waitcnt vmcnt(0)" ::: "memory");
    __syncthreads();
    if (threadIdx.x == 0) {
        unsigned* bar = b.bar;
        __builtin_amdgcn_s_waitcnt(0);
        unsigned nloc = b.st[0], nx = b.st[1];
        if (nloc == 0u) { xcd_barrier_complete(bar, b.x, nloc, nx); b.st[0] = nloc; b.st[1] = nx; }
        const unsigned old = xb_add(&bar[XB_XSUB(b.x)], 1u);
        const unsigned gen = old / nloc;
        if (old + 1u == (gen + 1u) * nloc) {
            __builtin_amdgcn_fence(__ATOMIC_RELEASE, "agent");
            asm volatile("s_waitcnt vmcnt(0)" ::: "memory");
            const unsigned og = xb_add(&bar[XB_TOP], 1u);
            const unsigned tg = og / nx;
            if (og + 1u == (tg + 1u) * nx) xb_add(&bar[XB_TOPGEN], 1u);
            else XB_SPIN(xb_ld(&bar[XB_TOPGEN]) == tg, bar);
            __builtin_amdgcn_fence(__ATOMIC_ACQUIRE, "agent");
            xb_add(&bar[XB_XGEN(b.x)], 1u);
            asm volatile("s_waitcnt vmcnt(0)" ::: "memory");
        } else {
            XB_SPIN(xb_ld(&bar[XB_XGEN(b.x)]) == gen, bar);
            __builtin_amdgcn_fence(__ATOMIC_ACQUIRE, "agent");
            asm volatile("s_waitcnt vmcnt(0)" ::: "memory");
        }
    }
    __syncthreads();
}
#ifndef MK_NSEQ
#define MK_NSEQ 24
#endif
namespace mk {
typedef unsigned short bf16;
typedef short bf16x8 __attribute__((ext_vector_type(8)));
typedef short s16x4 __attribute__((ext_vector_type(4)));
typedef float f32x4 __attribute__((ext_vector_type(4)));
typedef float f32x16 __attribute__((ext_vector_type(16)));
typedef unsigned u32x4 __attribute__((ext_vector_type(4)));
typedef unsigned u32x2 __attribute__((ext_vector_type(2)));
constexpr int NSEQ = MK_NSEQ, S = 2048, D = 1024, INW = 3584, MODW = 3072, DEPTH = 2, NPROMPT = 8, M = NSEQ * S, NWAVES = 8, NTHR = 512;
constexpr float LOG2E = 1.4426950408889634f, QSCALE = 0.125f * LOG2E;
constexpr size_t MiB = 1u << 20;
constexpr size_t WS_CTL = 0, CTL_ZERO_BYTES = 1 * MiB, WS_MOD = 1 * MiB, WS_ROPE = 2 * MiB, WS_WIN = 4 * MiB, WS_WOUT = 18 * MiB, WS_LSE = 22 * MiB, WS_BIG = 32 * MiB;
constexpr size_t SZ_MD = (size_t)M * D * 2, SZ_M512 = (size_t)M * 512 * 2, SZ_M256 = (size_t)M * 256 * 2;
constexpr size_t WS_H = WS_BIG, WS_O2 = WS_H, WS_ST = WS_H + SZ_M512;
constexpr size_t WS_QA = WS_H + SZ_MD, WS_KA = WS_QA + SZ_M512, WS_VA = WS_KA + SZ_M512, WS_QB = WS_VA + SZ_M512, WS_KB = WS_QB + SZ_M256, WS_VB = WS_KB + SZ_M256;
constexpr size_t WS_MIX = WS_VB + SZ_M512, WS_O1 = WS_MIX + SZ_MD, WS_END = WS_O1 + SZ_M512;
static_assert((size_t)NSEQ * 4 * 2 * 16 * 8192 * 2 == SZ_M512, "state buffer size");
static_assert((size_t)2 * M * 8 * 4 <= 10 * MiB, "lse");
constexpr int CW_TMO = 0, CW_BAR = 4096, CW_Q = 16384;
constexpr int RING_BYTES = 131072, LDSCTL_OFF = RING_BYTES, MISC_OFF = LDSCTL_OFF + 320, LDS_BYTES = 147456;

struct Args { const float* in[12]; float* out; unsigned char* ws; };

__device__ __forceinline__ unsigned cvtpk(float lo, float hi) { typedef float f2 __attribute__((ext_vector_type(2))); typedef __bf16 b2 __attribute__((ext_vector_type(2))); f2 v = {lo, hi}; b2 b = __builtin_convertvector(v, b2); return __builtin_bit_cast(unsigned, b); }
__device__ __forceinline__ float bflo(unsigned u) { return __uint_as_float(u << 16); }
__device__ __forceinline__ float bfhi(unsigned u) { return __uint_as_float(u & 0xffff0000u); }
__device__ __forceinline__ float fexp2(float x) { return __builtin_amdgcn_exp2f(x); }
__device__ __forceinline__ float silu_fast(float x) { return x * __builtin_amdgcn_rcpf(1.f + fexp2(-x * LOG2E)); }
__device__ __forceinline__ float swap_add(float v) { auto r = __builtin_amdgcn_permlane32_swap(__float_as_uint(v), __float_as_uint(v), false, false); return __uint_as_float(r[0]) + __uint_as_float(r[1]); }
__device__ __forceinline__ float swap_max(float v) { auto r = __builtin_amdgcn_permlane32_swap(__float_as_uint(v), __float_as_uint(v), false, false); return fmaxf(__uint_as_float(r[0]), __uint_as_float(r[1])); }
__device__ __forceinline__ s16x4 trrd(const LAS unsigned char* p) { typedef short v4 __attribute__((ext_vector_type(4))); return __builtin_bit_cast(s16x4, __builtin_amdgcn_ds_read_tr16_b64_v4i16((LAS v4*)p)); }
__device__ __forceinline__ bf16x8 trfrag(const LAS unsigned char* sub) { const s16x4 a = trrd(sub), b = trrd(sub + 512); return (bf16x8){a[0], a[1], a[2], a[3], b[0], b[1], b[2], b[3]}; }
__device__ __forceinline__ void glds16(const void* gsrc, LAS unsigned char* dst) { __builtin_amdgcn_global_load_lds((const GAS unsigned*)gsrc, (LAS unsigned*)dst, 16, 0, 0); }
__device__ __forceinline__ int crow(int r, int hi) { return (r & 3) + 8 * (r >> 2) + 4 * hi; }
__device__ __forceinline__ float wave_sum(float v) {
#pragma unroll
    for (int o = 1; o < 64; o <<= 1) v += __shfl_xor(v, o);
    return v;
}
__device__ __forceinline__ const float* xrow0(const float* xp, const float* xs, int m) { return m < NPROMPT * S ? xp + (size_t)m * D : xs + (size_t)(m - NPROMPT * S) * D; }
__device__ __forceinline__ float log2_sigmoid(float x) { return (fminf(x, 0.f) - log1pf(expf(-fabsf(x)))) * LOG2E; }

__device__ __forceinline__ int in_dest_row(int n) {
    const bool rope = (n < 1024) || (n >= 2048 && n < 2560);
    if (!rope) return n;
    const int d = n & 63, dd = d & 31;
    return (n & ~63) + 8 * (dd >> 2) + 4 * (d >> 5) + (dd & 3);
}
__device__ __forceinline__ void transpose_item(const float* W, int K, int N, bf16* WT, bool perm, LAS float* scr, int item, int lane) {
    const int nblk = N / 32, kb = item / nblk, nb = item % nblk, k0 = 64 * kb, n0 = 32 * nb;
#pragma unroll 8
    for (int i = 0; i < 32; ++i) { const int kk = 2 * i + (lane >> 5); scr[kk * 33 + (lane & 31)] = W[(size_t)(k0 + kk) * N + n0 + (lane & 31)]; }
    LDS_WAIT(); asm volatile("" ::: "memory");
    const int c = lane & 7;
#pragma unroll
    for (int j = 0; j < 4; ++j) { const int n = (lane >> 3) + 8 * j; const LAS float* s = scr + (8 * c) * 33 + n;
        u32x4 o; o.x = cvtpk(s[0 * 33], s[1 * 33]); o.y = cvtpk(s[2 * 33], s[3 * 33]); o.z = cvtpk(s[4 * 33], s[5 * 33]); o.w = cvtpk(s[6 * 33], s[7 * 33]);
        const int dr = perm ? in_dest_row(n0 + n) : n0 + n;
        *(GAS u32x4*)(WT + (size_t)dr * K + k0 + 8 * c) = o; }
    LDS_WAIT(); asm volatile("" ::: "memory");
}
__device__ __forceinline__ void p0_prologue(const Args& a, LAS unsigned char* lds, int tid, int lane, int wave, int G) {
    unsigned char* ws = a.ws;
    LAS float* scr = (LAS float*)(lds + wave * 16384);
    const int gw = blockIdx.x * NWAVES + wave, NGW = G * NWAVES;
    constexpr int I_IN = (D / 64) * (INW / 32), I_OUT = (D / 64) * (D / 32), NITEMS = DEPTH * (I_IN + I_OUT);
    for (int it = gw; it < NITEMS; it += NGW) {
        int r = it; const int l = r / (I_IN + I_OUT); r -= l * (I_IN + I_OUT);
        if (r < I_IN) transpose_item(a.in[7] + (size_t)l * D * INW, D, INW, (bf16*)(ws + WS_WIN) + (size_t)l * INW * D, true, scr, r, lane);
        else transpose_item(a.in[8] + (size_t)l * D * D, D, D, (bf16*)(ws + WS_WOUT) + (size_t)l * D * D, false, scr, r - I_IN, lane);
    }
    float* rope = (float*)(ws + WS_ROPE);
    for (int idx = blockIdx.x * NTHR + tid; idx < S * 32; idx += G * NTHR) { const int pos = idx >> 5, i = idx & 31;
        const float inv = powf(10000.f, -(float)(2 * i) / 64.f), ang = (float)pos * inv; rope[pos * 64 + i] = cosf(ang); rope[pos * 64 + 32 + i] = sinf(ang); }
    __syncthreads();
    for (int u = blockIdx.x; u < DEPTH * (MODW / 32); u += G) {
        const int l = u / (MODW / 32), j0 = (u % (MODW / 32)) * 32;
        LAS float* sc = (LAS float*)lds;
        for (int i = tid; i < NSEQ * D; i += NTHR) { const int b = i >> 10, k = i & 1023; const float c = (b < NPROMPT ? a.in[2] + b * D : a.in[3] + (b - NPROMPT) * D)[k]; sc[i] = c / (1.f + expf(-c)); }
        __syncthreads();
        const int col = lane & 31, ks = wave * 2 + (lane >> 5);
        float acc[NSEQ];
#pragma unroll
        for (int b = 0; b < NSEQ; ++b) acc[b] = 0.f;
        const float* wp = a.in[5] + (size_t)l * D * MODW + (size_t)(ks * 64) * MODW + j0 + col;
#pragma unroll 4
        for (int kk = 0; kk < 64; ++kk) { const float wv = wp[(size_t)kk * MODW];
#pragma unroll
            for (int b = 0; b < NSEQ; ++b) acc[b] += sc[b * D + ks * 64 + kk] * wv; }
        __syncthreads();
#pragma unroll
        for (int b = 0; b < NSEQ; ++b) sc[(ks * NSEQ + b) * 32 + col] = acc[b];
        __syncthreads();
        for (int i = tid; i < NSEQ * 32; i += NTHR) { const int b = i >> 5, c = i & 31; float s = 0.f;
            for (int k2 = 0; k2 < 16; ++k2) s += sc[(k2 * NSEQ + b) * 32 + c];
            ((float*)(ws + WS_MOD))[((size_t)l * NSEQ + b) * MODW + j0 + c] = s + a.in[6][l * MODW + j0 + c]; }
        __syncthreads();
    }
}
__device__ __forceinline__ void norm_phase(const Args& a, int layer, int lane, int wave, int G) {
    const int gw = blockIdx.x * NWAVES + wave, NGW = G * NWAVES;
    const float* mod = (const float*)(a.ws + WS_MOD); bf16* H = (bf16*)(a.ws + WS_H);
    for (int m = gw; m < M; m += NGW) {
        const float* xr = layer == 0 ? xrow0(a.in[0], a.in[1], m) : a.out + (size_t)m * D;
        const int b = m >> 11;
        f32x4 v[4]; float ss = 0.f;
#pragma unroll
        for (int j = 0; j < 4; ++j) { v[j] = *(const GAS f32x4*)(xr + 4 * lane + 256 * j); ss += (v[j].x * v[j].x + v[j].y * v[j].y) + (v[j].z * v[j].z + v[j].w * v[j].w); }
        const float rstd = rsqrtf(wave_sum(ss) * (1.f / D) + 1e-6f);
        const float* md = mod + ((size_t)layer * NSEQ + b) * MODW;
#pragma unroll
        for (int j = 0; j < 4; ++j) { const int k = 4 * lane + 256 * j;
            const f32x4 g = *(const GAS f32x4*)(a.in[4] + layer * D + k), sc = *(const GAS f32x4*)(md + D + k), sh = *(const GAS f32x4*)(md + k);
            const f32x4 hh = v[j] * rstd * g * (sc + 1.f) + sh;
            u32x2 w; w.x = cvtpk(hh.x, hh.y); w.y = cvtpk(hh.z, hh.w); *(GAS u32x2*)(H + (size_t)m * D + k) = w; }
    }
}
__device__ __forceinline__ void final_phase(const Args& a, int lane, int wave, int G) {
    const int gw = blockIdx.x * NWAVES + wave, NGW = G * NWAVES;
    for (int m = gw; m < M; m += NGW) {
        float* xr = a.out + (size_t)m * D; f32x4 v[4]; float ss = 0.f;
#pragma unroll
        for (int j = 0; j < 4; ++j) { v[j] = *(const GAS f32x4*)(xr + 4 * lane + 256 * j); ss += (v[j].x * v[j].x + v[j].y * v[j].y) + (v[j].z * v[j].z + v[j].w * v[j].w); }
        const float rstd = rsqrtf(wave_sum(ss) * (1.f / D) + 1e-6f);
#pragma unroll
        for (int j = 0; j < 4; ++j) { const int k = 4 * lane + 256 * j; const f32x4 g = *(const GAS f32x4*)(a.in[11] + k); *(GAS f32x4*)(xr + k) = v[j] * rstd * g; }
    }
}
struct EpiIn {
    static constexpr bool PERM = true, AFTER_DRAIN = false;
    unsigned char* ws;
    __device__ __forceinline__ void operator()(const pg8::f32x4 (&acc)[2][2][4][2], const pg8::Unit& u, int wr, int wc, int fr, int fq) const {
        const int pn = u.pn; bf16* base; int ld, c0, mode; float sc = 1.f;
        if (pn < 2) { base = (bf16*)(ws + WS_QA); ld = 512; c0 = pn * 256; mode = 1; sc = QSCALE; }
        else if (pn < 4) { base = (bf16*)(ws + WS_KA); ld = 512; c0 = (pn - 2) * 256; mode = 1; }
        else if (pn < 6) { base = (bf16*)(ws + WS_VA); ld = 512; c0 = (pn - 4) * 256; mode = 0; }
        else if (pn < 8) { base = (bf16*)(ws + WS_MIX); ld = 1024; c0 = (pn - 6) * 256; mode = 2; }
        else if (pn == 8) { base = (bf16*)(ws + WS_QB); ld = 256; c0 = 0; mode = 1; }
        else if (pn == 9) { base = (bf16*)(ws + WS_KB); ld = 256; c0 = 0; mode = 1; sc = 0.125f; }
        else if (pn < 12) { base = (bf16*)(ws + WS_VB); ld = 512; c0 = (pn - 10) * 256; mode = 0; }
        else { base = (bf16*)(ws + WS_MIX); ld = 1024; c0 = 512 + (pn - 12) * 256; mode = 2; }
        const int row0 = u.pm * 256 + wr * 64 + fr, colw = c0 + wc * 32 + 8 * fq, g = 4 * (wc & 1) + fq;
        const float* rope = (const float*)(ws + WS_ROPE);
        if (mode == 1) {
#pragma unroll
            for (int ai = 0; ai < 2; ++ai)
#pragma unroll
                for (int m = 0; m < 4; ++m) { const int row = row0 + ai * 128 + m * 16, pos = row & (S - 1);
                    const f32x4 cs = *(const GAS f32x4*)(rope + pos * 64 + 4 * g), sn = *(const GAS f32x4*)(rope + pos * 64 + 32 + 4 * g);
#pragma unroll
                    for (int bj = 0; bj < 2; ++bj) { const f32x4 v0 = acc[ai][bj][m][0], v1 = acc[ai][bj][m][1];
                        const f32x4 y0 = (v0 * cs - v1 * sn) * sc, y1 = (v1 * cs + v0 * sn) * sc;
                        u32x4 w; w.x = cvtpk(y0[0], y0[1]); w.y = cvtpk(y0[2], y0[3]); w.z = cvtpk(y1[0], y1[1]); w.w = cvtpk(y1[2], y1[3]);
                        *(GAS u32x4*)(base + (size_t)row * ld + colw + bj * 128) = w; }
                    asm volatile("" ::: "memory"); }
        } else if (mode == 2) {
#pragma unroll
            for (int ai = 0; ai < 2; ++ai)
#pragma unroll
                for (int m = 0; m < 4; ++m) { const int row = row0 + ai * 128 + m * 16;
#pragma unroll
                    for (int bj = 0; bj < 2; ++bj) { const f32x4 v0 = acc[ai][bj][m][0], v1 = acc[ai][bj][m][1];
                        u32x4 w; w.x = cvtpk(silu_fast(v0[0]), silu_fast(v0[1])); w.y = cvtpk(silu_fast(v0[2]), silu_fast(v0[3])); w.z = cvtpk(silu_fast(v1[0]), silu_fast(v1[1])); w.w = cvtpk(silu_fast(v1[2]), silu_fast(v1[3]));
                        *(GAS u32x4*)(base + (size_t)row * ld + colw + bj * 128) = w; } }
        } else {
#pragma unroll
            for (int ai = 0; ai < 2; ++ai)
#pragma unroll
                for (int m = 0; m < 4; ++m) { const int row = row0 + ai * 128 + m * 16;
#pragma unroll
                    for (int bj = 0; bj < 2; ++bj) { const f32x4 v0 = acc[ai][bj][m][0], v1 = acc[ai][bj][m][1];
                        u32x4 w; w.x = cvtpk(v0[0], v0[1]); w.y = cvtpk(v0[2], v0[3]); w.z = cvtpk(v1[0], v1[1]); w.w = cvtpk(v1[2], v1[3]);
                        *(GAS u32x4*)(base + (size_t)row * ld + colw + bj * 128) = w; } }
        }
    }
};
struct EpiOut {
    static constexpr bool PERM = false, AFTER_DRAIN = false;
    const float *xp, *xs; float* out; const float* gate; int layer;
    __device__ __forceinline__ void operator()(const pg8::f32x4 (&acc)[2][2][4][2], const pg8::Unit& u, int wr, int wc, int fr, int fq) const {
        const int row0 = u.pm * 256 + wr * 64 + fr, col0 = u.pn * 256 + wc * 32 + 4 * fq;
#pragma unroll
        for (int ai = 0; ai < 2; ++ai)
#pragma unroll
            for (int m = 0; m < 4; ++m) { const int row = row0 + ai * 128 + m * 16, b = row >> 11;
                const float* xr = layer == 0 ? xrow0(xp, xs, row) : out + (size_t)row * D; const float* gp = gate + (size_t)b * MODW;
#pragma unroll
                for (int bj = 0; bj < 2; ++bj)
#pragma unroll
                    for (int n = 0; n < 2; ++n) { const int c = col0 + bj * 128 + n * 16;
                        const f32x4 x4 = *(const GAS f32x4*)(xr + c), g4 = *(const GAS f32x4*)(gp + c);
                        *(GAS f32x4*)(out + (size_t)row * D + c) = x4 + g4 * acc[ai][bj][m][n]; } }
    }
};
template <bool MERGE> __device__ __forceinline__ void attn_unit(unsigned char* ws, LAS unsigned char* lds, int bh, int p, int v, int lane, int wave) {
    const int b = bh >> 3, h = bh & 7, r32 = lane & 31, hi = lane >> 5;
    const int dsh = 2 * p, L = S >> dsh;
    int cls0, l0;
    if (p == 0) { cls0 = 0; l0 = 256 * v; } else if (p == 1) { cls0 = v >> 1; l0 = 256 * (v & 1); } else { cls0 = 2 * v; l0 = 0; }
    const size_t seqrow = (size_t)b * S;
    const bf16* KA = (const bf16*)(ws + WS_KA) + seqrow * 512 + h * 64; const bf16* VA = (const bf16*)(ws + WS_VA) + seqrow * 512 + h * 64;
    LAS unsigned char* Kb = lds; LAS unsigned char* Vb = lds + 49152;
    const int nKp = MERGE ? 32 : 48, nRg = MERGE ? 16 : 24;
    for (int pc = wave; pc < nKp; pc += 8) { const int j = pc * 8 + (lane >> 3); int pos;
        if (MERGE) pos = (j & 127) * 16 + cls0 + (j >> 7); else { int lk = l0 - 64 + j; lk = lk < 0 ? 0 : (lk > L - 1 ? L - 1 : lk); pos = (lk << dsh) + cls0; }
        glds16(KA + (size_t)pos * 512 + (((lane & 7) ^ ((j >> 1) & 7)) << 3), Kb + pc * 1024); }
    for (int q = wave; q < 2 * nRg; q += 8) { const int dh = q >= nRg ? 1 : 0, rg = q - dh * nRg, j = rg * 16 + (lane >> 2); int pos;
        if (MERGE) pos = (j & 127) * 16 + cls0 + (j >> 7); else { int lk = l0 - 64 + j; lk = lk < 0 ? 0 : (lk > L - 1 ? L - 1 : lk); pos = (lk << dsh) + cls0; }
        glds16(VA + (size_t)pos * 512 + dh * 32 + (lane & 3) * 8, Vb + (dh * 24 + rg) * 1024); }
    const int ql = MERGE ? 32 * (wave & 3) + r32 : l0 + 32 * wave + r32, qcls = MERGE ? cls0 + (wave >> 2) : cls0;
    const size_t qrow = seqrow + (size_t)((ql << dsh) + qcls);
    bf16x8 qr[4];
    { const bf16* Q = (const bf16*)(ws + WS_QA) + qrow * 512 + h * 64 + hi * 8;
#pragma unroll
      for (int ks = 0; ks < 4; ++ks) qr[ks] = *(const GAS bf16x8*)(Q + ks * 16); }
    VM_WAIT(); __syncthreads();
    const int nt = MERGE ? 4 : 5, slot0 = MERGE ? 128 * (wave >> 2) : 32 * wave;
    const int dq = MERGE ? 32 * (wave & 3) : 64, kl0 = MERGE ? 0 : l0 - 64 + 32 * wave;
    const int troff = ((lane >> 4) & 1) * 32 + (lane & 3) * 8 + (4 * hi + ((lane & 15) >> 2)) * 64;
    float m_run = -1e30f, l_run = 0.f; f32x16 o0 = {}, o1 = {};
    for (int t = 0; t < nt; ++t) {
        const int wrow = slot0 + 32 * t, krow = wrow + r32, sw = (krow >> 1) & 7;
        const LAS unsigned char* kp = Kb + krow * 128;
        f32x16 s = {};
#pragma unroll
        for (int ks = 0; ks < 4; ++ks) { const bf16x8 kf = *(const LAS bf16x8*)(kp + (((2 * ks + hi) ^ sw) << 4)); s = __builtin_amdgcn_mfma_f32_32x32x16_bf16(kf, qr[ks], s, 0, 0, 0); }
        const int klb = kl0 + 32 * t, dbase = dq + r32 - 32 * t;
        float tm = -INFINITY;
#pragma unroll
        for (int r = 0; r < 16; ++r) { const int cr = crow(r, hi), kl = klb + cr, df = dbase - cr; const bool ok = (kl >= 0) & (kl < L) & (df <= 64) & (df >= -64); s[r] = ok ? s[r] : -INFINITY; tm = fmaxf(tm, s[r]); }
        tm = swap_max(tm);
        if (__any(tm > m_run + 8.f)) { const float mn = fmaxf(m_run, tm), f = fexp2(m_run - mn); l_run *= f; o0 = o0 * f; o1 = o1 * f; m_run = mn; }
        float ls = 0.f;
#pragma unroll
        for (int r = 0; r < 16; ++r) { s[r] = fexp2(s[r] - m_run); ls += s[r]; }
        l_run += ls;
        u32x4 w0, w1; w0.x = cvtpk(s[0], s[1]); w0.y = cvtpk(s[2], s[3]); w0.z = cvtpk(s[4], s[5]); w0.w = cvtpk(s[6], s[7]); w1.x = cvtpk(s[8], s[9]); w1.y = cvtpk(s[10], s[11]); w1.z = cvtpk(s[12], s[13]); w1.w = cvtpk(s[14], s[15]);
        const bf16x8 pf0 = __builtin_bit_cast(bf16x8, w0), pf1 = __builtin_bit_cast(bf16x8, w1);
        const LAS unsigned char* vp = Vb + (wrow >> 4) * 1024 + troff;
        o0 = __builtin_amdgcn_mfma_f32_32x32x16_bf16(trfrag(vp), pf0, o0, 0, 0, 0);
        o0 = __builtin_amdgcn_mfma_f32_32x32x16_bf16(trfrag(vp + 1024), pf1, o0, 0, 0, 0);
        o1 = __builtin_amdgcn_mfma_f32_32x32x16_bf16(trfrag(vp + 24576), pf0, o1, 0, 0, 0);
        o1 = __builtin_amdgcn_mfma_f32_32x32x16_bf16(trfrag(vp + 24576 + 1024), pf1, o1, 0, 0, 0);
    }
    const float ltot = swap_add(l_run), il = __builtin_amdgcn_rcpf(ltot), lse = m_run + __builtin_amdgcn_logf(ltot);
    float* LSE = (float*)(ws + WS_LSE);
    if (!MERGE) {
        if (hi == 0) LSE[((size_t)p * M + qrow) * 8 + h] = lse;
        bf16* OP = (bf16*)(ws + (p == 0 ? WS_O1 : WS_O2)) + qrow * 512 + h * 64 + 4 * hi;
#pragma unroll
        for (int g4 = 0; g4 < 4; ++g4) {
            u32x2 a; a.x = cvtpk(o0[4 * g4] * il, o0[4 * g4 + 1] * il); a.y = cvtpk(o0[4 * g4 + 2] * il, o0[4 * g4 + 3] * il); *(GAS u32x2*)(OP + 8 * g4) = a;
            u32x2 c; c.x = cvtpk(o1[4 * g4] * il, o1[4 * g4 + 1] * il); c.y = cvtpk(o1[4 * g4 + 2] * il, o1[4 * g4 + 3] * il); *(GAS u32x2*)(OP + 32 + 8 * g4) = c; }
    } else {
        const float l1 = LSE[((size_t)0 * M + qrow) * 8 + h], l2 = LSE[((size_t)1 * M + qrow) * 8 + h];
        const float mx = fmaxf(lse, fmaxf(l1, l2)), wa = fexp2(l1 - mx), wb = fexp2(l2 - mx), wc = fexp2(lse - mx), iw = __builtin_amdgcn_rcpf(wa + wb + wc);
        const float ca = wa * iw, cb = wb * iw, cc = wc * iw * il;
        const bf16* O1 = (const bf16*)(ws + WS_O1) + qrow * 512 + h * 64 + 4 * hi; const bf16* O2 = (const bf16*)(ws + WS_O2) + qrow * 512 + h * 64 + 4 * hi;
        bf16* MX = (bf16*)(ws + WS_MIX) + qrow * 1024 + h * 64 + 4 * hi;
#pragma unroll
        for (int dh = 0; dh < 2; ++dh)
#pragma unroll
            for (int g4 = 0; g4 < 4; ++g4) { const int off = 32 * dh + 8 * g4;
                const u32x2 a = *(const GAS u32x2*)(O1 + off), c = *(const GAS u32x2*)(O2 + off), g = *(const GAS u32x2*)(MX + off);
                const float e0 = dh ? o1[4 * g4] : o0[4 * g4], e1 = dh ? o1[4 * g4 + 1] : o0[4 * g4 + 1], e2 = dh ? o1[4 * g4 + 2] : o0[4 * g4 + 2], e3 = dh ? o1[4 * g4 + 3] : o0[4 * g4 + 3];
                const float y0 = (ca * bflo(a.x) + cb * bflo(c.x) + cc * e0) * bflo(g.x), y1 = (ca * bfhi(a.x) + cb * bfhi(c.x) + cc * e1) * bfhi(g.x);
                const float y2 = (ca * bflo(a.y) + cb * bflo(c.y) + cc * e2) * bflo(g.y), y3 = (ca * bfhi(a.y) + cb * bfhi(c.y) + cc * e3) * bfhi(g.y);
                u32x2 w; w.x = cvtpk(y0, y1); w.y = cvtpk(y2, y3); *(GAS u32x2*)(MX + off) = w; }
    }
    __syncthreads();
}
__device__ __forceinline__ void ret_scan_unit(const Args& a, LAS unsigned char* lds, int layer, int u, int tid, int lane, int wave) {
    unsigned char* ws = a.ws;
    const int dir = u & 1, bh = u >> 1, b = bh >> 2, h = bh & 3, hi = lane >> 5;
    const float lg2 = log2_sigmoid((dir ? a.in[10] : a.in[9])[layer * 4 + h]), G128 = fexp2(128.f * lg2);
    const size_t seqrow = (size_t)b * S;
    const bf16* KB = (const bf16*)(ws + WS_KB) + seqrow * 256 + h * 64; const bf16* VB = (const bf16*)(ws + WS_VB) + seqrow * 512 + h * 128;
    bf16* ST = (bf16*)(ws + WS_ST) + (size_t)((bh * 2 + dir) * 16) * 8192;
    const int eb = wave >> 2, fb = wave & 3;
    const int troff = ((lane >> 4) & 1) * 32 + (lane & 3) * 8 + (4 * hi + ((lane & 15) >> 2)) * 64;
    f32x16 acc = {};
    u32x4 kreg[2], vreg[4];
#define RS_LOAD_CHUNK(cc) do { _Pragma("unroll") for (int i_ = 0; i_ < 2; ++i_) { const int pi_ = tid + 512 * i_, row_ = pi_ >> 3, ch_ = pi_ & 7; kreg[i_] = *(const GAS u32x4*)(KB + (size_t)((cc) * 128 + row_) * 256 + ch_ * 8); } \
        _Pragma("unroll") for (int i_ = 0; i_ < 4; ++i_) { const int pi_ = tid + 512 * i_, row_ = pi_ >> 4, ch_ = pi_ & 15; vreg[i_] = *(const GAS u32x4*)(VB + (size_t)((cc) * 128 + row_) * 512 + ch_ * 8); } } while (0)
    RS_LOAD_CHUNK(dir ? 15 : 0);
    for (int step = 0; step < 16; ++step) {
        const int c = dir ? 15 - step : step;
#pragma unroll
        for (int i = 0; i < 2; ++i) { const int pi = tid + 512 * i, row = pi >> 3, ch = pi & 7; const float fac = fexp2(lg2 * (float)(dir ? row : 127 - row));
            u32x4 k = kreg[i], o; o.x = cvtpk(bflo(k.x) * fac, bfhi(k.x) * fac); o.y = cvtpk(bflo(k.y) * fac, bfhi(k.y) * fac); o.z = cvtpk(bflo(k.z) * fac, bfhi(k.z) * fac); o.w = cvtpk(bflo(k.w) * fac, bfhi(k.w) * fac);
            *(LAS u32x4*)(lds + ((row >> 4) * 2 + (ch >> 2)) * 1024 + (row & 15) * 64 + (ch & 3) * 16) = o; }
#pragma unroll
        for (int i = 0; i < 4; ++i) { const int pi = tid + 512 * i, row = pi >> 4, ch = pi & 15; *(LAS u32x4*)(lds + 16384 + ((row >> 4) * 4 + (ch >> 2)) * 1024 + (row & 15) * 64 + (ch & 3) * 16) = vreg[i]; }
        __syncthreads();
        if (step < 15) RS_LOAD_CHUNK(dir ? 14 - step : step + 1);
        { bf16* sp = ST + (size_t)c * 8192 + (size_t)(32 * fb + (lane & 31)) * 64 + 32 * eb + 4 * hi;
#pragma unroll
          for (int g4 = 0; g4 < 4; ++g4) { u32x2 w; w.x = cvtpk(acc[4 * g4], acc[4 * g4 + 1]); w.y = cvtpk(acc[4 * g4 + 2], acc[4 * g4 + 3]); *(GAS u32x2*)(sp + 8 * g4) = w; } }
        if (step < 15) {
            acc = acc * G128;
#pragma unroll
            for (int ks = 0; ks < 8; ++ks) acc = __builtin_amdgcn_mfma_f32_32x32x16_bf16(trfrag(lds + (ks * 2 + eb) * 1024 + troff), trfrag(lds + 16384 + (ks * 4 + fb) * 1024 + troff), acc, 0, 0, 0);
        }
        __syncthreads();
    }
}
__device__ __forceinline__ void ret_out_unit(const Args& a, LAS unsigned char* lds, int layer, int u, int tid, int lane, int wave) {
    unsigned char* ws = a.ws;
    const int c = u & 15, bh = u >> 4, b = bh >> 2, h = bh & 3, r32 = lane & 31, hi = lane >> 5, tb = wave >> 1, fh = wave & 1;
    const float lg2f = log2_sigmoid(a.in[9][layer * 4 + h]), lg2b = log2_sigmoid(a.in[10][layer * 4 + h]);
    const size_t row0 = (size_t)b * S + c * 128;
    const bf16* VB = (const bf16*)(ws + WS_VB) + row0 * 512 + h * 128;
#pragma unroll
    for (int i = 0; i < 4; ++i) { const int pi = tid + 512 * i, row = pi >> 4, ch = pi & 15; const u32x4 vv = *(const GAS u32x4*)(VB + (size_t)row * 512 + ch * 8);
        *(LAS u32x4*)(lds + ((row >> 4) * 4 + (ch >> 2)) * 1024 + (row & 15) * 64 + (ch & 3) * 16) = vv; }
    const int tt = 32 * tb + r32;
    bf16x8 qf[4];
    { const bf16* Q = (const bf16*)(ws + WS_QB) + (row0 + tt) * 256 + h * 64 + hi * 8;
#pragma unroll
      for (int ks = 0; ks < 4; ++ks) qf[ks] = *(const GAS bf16x8*)(Q + ks * 16); }
    f32x16 o[2];
    { const float cf = fexp2(lg2f * (float)(tt + 1)), cb = fexp2(lg2b * (float)(128 - tt));
      const bf16* Sf = (const bf16*)(ws + WS_ST) + (size_t)((bh * 2 + 0) * 16 + c) * 8192; const bf16* Sb = (const bf16*)(ws + WS_ST) + (size_t)((bh * 2 + 1) * 16 + c) * 8192;
#pragma unroll
      for (int k = 0; k < 2; ++k) { const int f = 32 * (2 * fh + k) + r32; f32x16 tf = {}, tbk = {};
#pragma unroll
          for (int ks = 0; ks < 4; ++ks) { tf = __builtin_amdgcn_mfma_f32_32x32x16_bf16(*(const GAS bf16x8*)(Sf + (size_t)f * 64 + 16 * ks + 8 * hi), qf[ks], tf, 0, 0, 0);
                                          tbk = __builtin_amdgcn_mfma_f32_32x32x16_bf16(*(const GAS bf16x8*)(Sb + (size_t)f * 64 + 16 * ks + 8 * hi), qf[ks], tbk, 0, 0, 0); }
          o[k] = tf * cf + tbk * cb; } }
    __syncthreads();
    const int troff = ((lane >> 4) & 1) * 32 + (lane & 3) * 8 + (4 * hi + ((lane & 15) >> 2)) * 64;
    const bf16* KB = (const bf16*)(ws + WS_KB) + row0 * 256 + h * 64 + hi * 8;
#pragma unroll
    for (int st = 0; st < 4; ++st) {
        f32x16 s = {};
#pragma unroll
        for (int ks = 0; ks < 4; ++ks) s = __builtin_amdgcn_mfma_f32_32x32x16_bf16(*(const GAS bf16x8*)(KB + (size_t)(32 * st + r32) * 256 + ks * 16), qf[ks], s, 0, 0, 0);
#pragma unroll
        for (int r = 0; r < 16; ++r) { const int df = tt - (32 * st + crow(r, hi)); const float fac = df >= 0 ? fexp2(lg2f * (float)df) : fexp2(lg2b * (float)(-df)); s[r] *= fac; }
        u32x4 w0, w1; w0.x = cvtpk(s[0], s[1]); w0.y = cvtpk(s[2], s[3]); w0.z = cvtpk(s[4], s[5]); w0.w = cvtpk(s[6], s[7]); w1.x = cvtpk(s[8], s[9]); w1.y = cvtpk(s[10], s[11]); w1.z = cvtpk(s[12], s[13]); w1.w = cvtpk(s[14], s[15]);
        const bf16x8 pf0 = __builtin_bit_cast(bf16x8, w0), pf1 = __builtin_bit_cast(bf16x8, w1);
#pragma unroll
        for (int k = 0; k < 2; ++k) { const LAS unsigned char* vp = lds + ((2 * st) * 4 + 2 * fh + k) * 1024 + troff;
            o[k] = __builtin_amdgcn_mfma_f32_32x32x16_bf16(trfrag(vp), pf0, o[k], 0, 0, 0);
            o[k] = __builtin_amdgcn_mfma_f32_32x32x16_bf16(trfrag(vp + 4096), pf1, o[k], 0, 0, 0); }
    }
    float ss = 0.f;
#pragma unroll
    for (int r = 0; r < 16; ++r) ss += o[0][r] * o[0][r] + o[1][r] * o[1][r];
    ss = swap_add(ss);
    LAS float* red = (LAS float*)(lds + 32768);
    if (hi == 0) red[wave * 32 + r32] = ss;
    __syncthreads();
    const float rstd = rsqrtf((ss + red[(wave ^ 1) * 32 + r32]) * (1.f / 128.f) + 1e-6f);
    bf16* MX = (bf16*)(ws + WS_MIX) + (row0 + tt) * 1024 + 512 + h * 128 + 64 * fh + 4 * hi;
#pragma unroll
    for (int k = 0; k < 2; ++k)
#pragma unroll
        for (int g4 = 0; g4 < 4; ++g4) { const int off = 32 * k + 8 * g4; const u32x2 g = *(const GAS u32x2*)(MX + off);
            u32x2 w; w.x = cvtpk(o[k][4 * g4] * rstd * bflo(g.x), o[k][4 * g4 + 1] * rstd * bfhi(g.x)); w.y = cvtpk(o[k][4 * g4 + 2] * rstd * bflo(g.y), o[k][4 * g4 + 3] * rstd * bfhi(g.y));
            *(GAS u32x2*)(MX + off) = w; }
    __syncthreads();
}
__device__ __forceinline__ int next_unit(gu32* ctr, volatile LAS unsigned* slot, int tid) {
    if (tid == 0) slot[0] = __hip_atomic_fetch_add(ctr, 1u, __ATOMIC_RELAXED, __HIP_MEMORY_SCOPE_AGENT);
    __syncthreads();
    const int u = (int)slot[0];
    __syncthreads();
    return u;
}
constexpr int NR1 = NSEQ * 4 * 2, NATT = NSEQ * 8 * 8, NR2 = NSEQ * 4 * 16;

#ifndef MK_PH_LO
#define MK_PH_LO 0
#endif
#ifndef MK_PH_HI
#define MK_PH_HI 99
#endif
__global__ void __launch_bounds__(NTHR, 2) fwd_megakernel(Args a) {
    extern __shared__ __attribute__((aligned(16))) unsigned char lds_raw[];
    LAS unsigned char* lds = (LAS unsigned char*)lds_raw;
    volatile LAS unsigned* MISC = (volatile LAS unsigned*)(lds + MISC_OFF);
    const int tid = threadIdx.x, wave = __builtin_amdgcn_readfirstlane(tid >> 6), G = gridDim.x;
    gu32* ctl = (gu32*)(a.ws + WS_CTL);
    for (int u = tid; u < (LDS_BYTES - LDSCTL_OFF) / 4; u += NTHR) ((LAS unsigned*)(lds + LDSCTL_OFF))[u] = 0u;
    __syncthreads();
    XcdBarrier bar = xcd_barrier_post((unsigned*)(ctl + CW_BAR), MISC + 8);
    int ph = 0;
#define PHASE_ON() (ph >= MK_PH_LO && ph < MK_PH_HI)
#define FRESH() int tid_ = threadIdx.x; asm volatile("" : "+v"(tid_)); const int lane_ = tid_ & 63; (void)lane_
#define END_PHASE() do { xcd_barrier(bar); ++ph; } while (0)
#ifndef SKIP_P0
    if (PHASE_ON()) { FRESH(); p0_prologue(a, lds, tid_, lane_, wave, G); }
#endif
    END_PHASE();
#ifndef SKIP_N
    if (PHASE_ON()) { FRESH(); norm_phase(a, 0, lane_, wave, G); }
#endif
    END_PHASE();
    for (int layer = 0; layer < DEPTH; ++layer) {
#ifndef SKIP_G1
        if (PHASE_ON()) { pg8::Gemm g{(const pg8::bf16_t*)(a.ws + WS_H), (const pg8::bf16_t*)(a.ws + WS_WIN) + (size_t)layer * INW * D, M, INW, D}; pg8::StaticOrder so; so.init(M, INW, G, (int)blockIdx.x);
            EpiIn E{a.ws}; pg8::gemm_phase<EpiIn, pg8::StaticOrder, true, true>(lds, g, so, E); }
#endif
        END_PHASE();
        if (PHASE_ON()) { FRESH(); gu32* ctr = ctl + CW_Q + 64 * (2 * layer);
            for (;;) { const int u = next_unit(ctr, MISC, tid_); if (u >= NR1 + 2 * NATT) break;
#ifndef SKIP_R1
                if (u < NR1) ret_scan_unit(a, lds, layer, u, tid_, lane_, wave);
                else
#endif
                { const int q = u - NR1;
#ifndef SKIP_A
                    attn_unit<false>(a.ws, lds, q >> 4, (q >> 3) & 1, q & 7, lane_, wave);
#endif
                } } }
        END_PHASE();
        if (PHASE_ON()) { FRESH(); gu32* ctr = ctl + CW_Q + 64 * (2 * layer + 1);
            for (;;) { const int u = next_unit(ctr, MISC, tid_); if (u >= NR2 + NATT) break;
#ifndef SKIP_R2
                if (u < NR2) ret_out_unit(a, lds, layer, u, tid_, lane_, wave);
                else
#endif
                { const int q = u - NR2;
#ifndef SKIP_AM
                    attn_unit<true>(a.ws, lds, q >> 3, 2, q & 7, lane_, wave);
#endif
                } } }
        END_PHASE();
#ifndef SKIP_G2
        if (PHASE_ON()) { pg8::Gemm g{(const pg8::bf16_t*)(a.ws + WS_MIX), (const pg8::bf16_t*)(a.ws + WS_WOUT) + (size_t)layer * D * D, M, D, D}; pg8::StaticOrder so; so.init(M, D, G, (int)blockIdx.x);
            EpiOut E{a.in[0], a.in[1], a.out, (const float*)(a.ws + WS_MOD) + (size_t)layer * NSEQ * MODW + 2048, layer}; pg8::gemm_phase<EpiOut, pg8::StaticOrder, true, true>(lds, g, so, E); }
#endif
        END_PHASE();
        if (layer == 0) { if (PHASE_ON()) { FRESH(); norm_phase(a, 1, lane_, wave, G); } END_PHASE(); }
    }
    if (PHASE_ON()) { FRESH(); final_phase(a, lane_, wave, G); }
}
inline void launch(void* const* d_in, void* d_out, void* d_ws, hipStream_t stream) {
    static int grid = 0;
    if (grid == 0) {
        int dev = 0, cus = 0;
        if (hipGetDevice(&dev) != hipSuccess || hipDeviceGetAttribute(&cus, hipDeviceAttributeMultiprocessorCount, dev) != hipSuccess) { fprintf(stderr, "kernel_launch: device query failed\n"); grid = -1; return; }
        if (hipFuncSetAttribute((const void*)fwd_megakernel, hipFuncAttributeMaxDynamicSharedMemorySize, LDS_BYTES) != hipSuccess) { fprintf(stderr, "kernel_launch: hipFuncSetAttribute failed\n"); grid = -1; return; }
        (void)hipGetLastError();
        grid = cus;
    }
    if (grid < 0) return;
    (void)hipMemsetAsync((char*)d_ws + WS_CTL, 0, CTL_ZERO_BYTES, stream);
    Args a{};
    for (int i = 0; i < 12; ++i) a.in[i] = (const float*)d_in[i];
    a.out = (float*)d_out; a.ws = (unsigned char*)d_ws;
    hipLaunchKernelGGL(fwd_megakernel, dim3(grid), dim3(NTHR), LDS_BYTES, stream, a);
}
}
extern "C" void kernel_launch(void* const* d_in, const int* in_sizes, int n_in, void* d_out, int out_size, void* d_ws, size_t ws_size, hipStream_t stream) {
    if (n_in != 12 || out_size != mk::M * mk::D || ws_size < mk::WS_END) { fprintf(stderr, "kernel_launch: unexpected shapes (n_in %d out %d ws %zu need %zu)\n", n_in, out_size, ws_size, (size_t)mk::WS_END); return; }
    mk::launch(d_in, d_out, d_ws, stream);
}
```
